# Optimizing an MI355X kernel written in HIP

```python
import math
import jax, jax.numpy as jnp
from jax import lax
import numpy as np

D_MODEL = 1024
BATCH = 8
SEQ = 2048
DEPTH = 1

GDN_HEADS = 8
GDN_HEAD_DIM = 128
GDN_WIDTH = GDN_HEADS * GDN_HEAD_DIM
GDN_CHUNK = 64
CONV_K = 5
DIL_GROUPS = ((128, 1), (512, 4), (2048, 16))
DIL_N_GROUPS = 3
DIL_HEADS_PER_GROUP = 4
DIL_HEADS = DIL_N_GROUPS * DIL_HEADS_PER_GROUP
DIL_HEAD_DIM = 128
DIL_WIDTH = DIL_HEADS * DIL_HEAD_DIM
DIL_OUT_WIDTH = DIL_HEADS_PER_GROUP * DIL_HEAD_DIM
DIL_BLOCK = 64
REL_BUCKETS = 32
REL_MAX_DIST = 1024
D_FF = 4 * D_MODEL
EPS = 1e-6
NEG = -1e30

C_QA = 0
C_KA = C_QA + GDN_WIDTH
C_VA = C_KA + GDN_WIDTH
C_ZA = C_VA + GDN_WIDTH
C_AF = C_ZA + GDN_WIDTH
C_AB = C_AF + GDN_HEADS
C_BF = C_AB + GDN_HEADS
C_BB = C_BF + GDN_HEADS
C_QB = C_BB + GDN_HEADS
C_KB = C_QB + DIL_WIDTH
C_VB = C_KB + DIL_WIDTH
C_GA = C_VB + DIL_WIDTH
C_GB = C_GA + D_MODEL
IN_COLS = C_GB + D_MODEL

kernel_name = "hybrid_gdn_dilated_attn_block"


def _rmsnorm(x, w):
    xf = x.astype(jnp.float32)
    y = xf * lax.rsqrt(jnp.mean(xf * xf, axis=-1, keepdims=True) + EPS) * w.astype(jnp.float32)
    return y.astype(x.dtype)


def _l2norm(x):
    return x * lax.rsqrt(jnp.sum(x * x, axis=-1, keepdims=True) + EPS)


def _t5_bucket(rel):
    nb = REL_BUCKETS // 2
    ret = (rel > 0).astype(np.int32) * nb
    n = np.abs(rel)
    max_exact = nb // 2
    large = max_exact + (np.log(np.maximum(n, 1) / max_exact) / math.log(REL_MAX_DIST / max_exact)
                         * (nb - max_exact)).astype(np.int32)
    large = np.minimum(large, nb - 1)
    return ret + np.where(n < max_exact, n, large).astype(np.int32)


def _chunk_gated_delta(q, k, v, g, beta):
    b, s, h, dk = q.shape
    dv = v.shape[-1]
    n = s // GDN_CHUNK

    def chunks(t):
        return jnp.moveaxis(t.reshape(b, n, GDN_CHUNK, h, -1), 3, 1)

    qc, kc, vc = chunks(q), chunks(k), chunks(v)
    gc = jnp.cumsum(chunks(g[..., None])[..., 0], axis=-1)
    bc = chunks(beta[..., None])
    tri = np.tril(np.ones((GDN_CHUNK, GDN_CHUNK), bool))
    strict = np.tril(np.ones((GDN_CHUNK, GDN_CHUNK), bool), -1)
    dd = gc[..., :, None] - gc[..., None, :]
    gam = jnp.where(tri, jnp.exp(jnp.where(tri, dd, 0.0)), 0.0)
    kb = kc * bc
    a_kk = jnp.where(strict, jnp.einsum('bhnic,bhnjc->bhnij', kb, kc) * gam, 0.0)
    eye = jnp.eye(GDN_CHUNK, dtype=a_kk.dtype)
    rhs = jnp.concatenate([vc * bc, kb * jnp.exp(gc)[..., None]], axis=-1)
    sol = lax.linalg.triangular_solve(a_kk + eye, rhs, left_side=True, lower=True,
                                      unit_diagonal=True)
    u, w = sol[..., :dv], sol[..., dv:]
    a_qk = jnp.einsum('bhnic,bhnjc->bhnij', qc, kc) * gam

    def step(state, inp):
        qn, kn, un, wn, gn, aqk = inp
        v_new = un - jnp.einsum('bhck,bhkv->bhcv', wn, state)
        o = (jnp.einsum('bhck,bhkv->bhcv', qn * jnp.exp(gn)[..., None], state)
             + jnp.einsum('bhij,bhjv->bhiv', aqk, v_new))
        g_last = gn[..., -1]
        state = (state * jnp.exp(g_last)[..., None, None]
                 + jnp.einsum('bhck,bhcv->bhkv', kn * jnp.exp(g_last[..., None] - gn)[..., None], v_new))
        return state, o

    xs = tuple(jnp.moveaxis(t, 2, 0) for t in (qc, kc, u, w, gc, a_qk))
    state0 = jnp.zeros((b, h, dk, dv), jnp.float32)
    _, o = lax.scan(step, state0, xs)
    o = jnp.moveaxis(o, 0, 2)
    return jnp.moveaxis(o, 1, 3).reshape(b, s, h, dv)


def _dilated_group(q, k, v, bias, dil, half):
    b, s, h, hd = q.shape
    blk = DIL_BLOCK
    L = s // dil
    nb = -(-L // blk)
    lp = nb * blk

    def res(t):
        return t.reshape(b, L, dil, h, hd).transpose(0, 2, 1, 3, 4)

    qr = jnp.pad(res(q), ((0, 0), (0, 0), (0, lp - L), (0, 0), (0, 0))).reshape(b, dil, nb, blk, h, hd)

    def win(t):
        tp = jnp.pad(res(t), ((0, 0), (0, 0), (blk, lp - L + blk), (0, 0), (0, 0)))
        tp = tp.reshape(b, dil, nb + 2, blk, h, hd)
        return jnp.concatenate([tp[:, :, :-2], tp[:, :, 1:-1], tp[:, :, 2:]], axis=3)

    kw, vw = win(k), win(v)
    off = np.arange(3 * blk)[None, :] - blk - np.arange(blk)[:, None]
    band = np.abs(off) <= half
    key_pos = np.arange(nb)[:, None] * blk - blk + np.arange(3 * blk)[None, :]
    key_ok = (key_pos >= 0) & (key_pos < L)
    mask = band[None] & key_ok[:, None, :]
    logits = (jnp.einsum('brnqhc,brnkhc->brnhqk', qr, kw) * (hd ** -0.5)
              + bias.astype(jnp.float32))
    logits = jnp.where(mask[:, None], logits, NEG)
    lse = jax.nn.logsumexp(logits, axis=-1)
    p = jnp.exp(logits - lse[..., None])
    o = jnp.einsum('brnhqk,brnkhc->brnqhc', p, vw).reshape(b, dil, lp, h, hd)[:, :, :L]
    o = o.transpose(0, 2, 1, 3, 4).reshape(b, s, h, hd)
    lse = lse.transpose(0, 1, 2, 4, 3).reshape(b, dil, lp, h)[:, :, :L]
    lse = lse.transpose(0, 2, 1, 3).reshape(b, s, h)
    return o, lse


def _gdn_decay(a, a_log, dt_bias):
    return -jnp.exp(a_log.astype(jnp.float32)) * jax.nn.softplus(a + dt_bias.astype(jnp.float32))


def setup_inputs(seed: int = 0) -> dict:
    key = jax.random.key(seed)
    ks = jax.random.split(key, 24)
    f32 = jnp.float32

    def nrm(k, shape, scale):
        return jax.random.normal(k, shape, f32) * scale

    def gain(k, shape):
        return 1.0 + 0.05 * jax.random.normal(k, shape, f32)

    dt = jnp.exp(jax.random.uniform(ks[6], (2, DEPTH, GDN_HEADS), f32, math.log(1e-3), math.log(1e-1)))
    dt_bias = dt + jnp.log(-jnp.expm1(-dt))
    a_log = jnp.log(jax.random.uniform(ks[7], (2, DEPTH, GDN_HEADS), f32, 1.0, 16.0))
    return {
        "x": jax.random.normal(ks[0], (BATCH, SEQ, D_MODEL), f32),
        "rel_bias": nrm(ks[1], (REL_BUCKETS, DIL_HEADS), 0.5),
        "ln_mix_pre": gain(ks[2], (DEPTH, D_MODEL)),
        "w_in": nrm(ks[3], (DEPTH, D_MODEL, IN_COLS), D_MODEL ** -0.5),
        "conv_w": nrm(ks[4], (DEPTH, CONV_K, 3 * GDN_WIDTH), CONV_K ** -0.5),
        "a_log_f": a_log[0],
        "a_log_b": a_log[1],
        "dt_bias_f": dt_bias[0],
        "dt_bias_b": dt_bias[1],
        "norm_a": gain(ks[5], (DEPTH, GDN_HEAD_DIM)),
        "w_branch_a": nrm(ks[8], (DEPTH, GDN_WIDTH, D_MODEL), GDN_WIDTH ** -0.5),
        "w_branch_b": nrm(ks[9], (DEPTH, DIL_OUT_WIDTH, D_MODEL), DIL_OUT_WIDTH ** -0.5),
        "w_out": nrm(ks[10], (DEPTH, D_MODEL, D_MODEL), D_MODEL ** -0.5),
        "ln_mix_post": gain(ks[11], (DEPTH, D_MODEL)),
        "ln_mlp_pre": gain(ks[12], (DEPTH, D_MODEL)),
        "w_ff1": nrm(ks[13], (DEPTH, D_MODEL, D_FF), D_MODEL ** -0.5),
        "w_ff2": nrm(ks[14], (DEPTH, D_FF, D_MODEL), D_FF ** -0.5),
        "ln_mlp_post": gain(ks[15], (DEPTH, D_MODEL)),
    }


def reference(x, rel_bias, ln_mix_pre, w_in, conv_w, a_log_f, a_log_b, dt_bias_f, dt_bias_b,
              norm_a, w_branch_a, w_branch_b, w_out, ln_mix_post, ln_mlp_pre, w_ff1, w_ff2,
              ln_mlp_post):
    b, s, _ = x.shape
    f32 = jnp.float32
    blk = DIL_BLOCK
    off = np.arange(3 * blk)[None, :] - blk - np.arange(blk)[:, None]
    group_bias = []
    for gi, (window, dil) in enumerate(DIL_GROUPS):
        bt = rel_bias[_t5_bucket(off * dil)]
        hs = slice(gi * DIL_HEADS_PER_GROUP, (gi + 1) * DIL_HEADS_PER_GROUP)
        group_bias.append(jnp.transpose(bt[:, :, hs], (2, 0, 1)))

    for l in range(DEPTH):
        h = _rmsnorm(x, ln_mix_pre[l])
        proj = jnp.einsum('bsd,dc->bsc', h, w_in[l]).astype(f32)

        qkv = lax.conv_general_dilated(
            proj[..., C_QA:C_ZA], conv_w[l].astype(f32)[:, None, :], window_strides=(1,),
            padding=[(CONV_K // 2, CONV_K // 2)], dimension_numbers=('NWC', 'WIO', 'NWC'),
            feature_group_count=3 * GDN_WIDTH)
        qkv = jax.nn.silu(qkv)
        qa = _l2norm(qkv[..., :GDN_WIDTH].reshape(b, s, GDN_HEADS, GDN_HEAD_DIM)) * (GDN_HEAD_DIM ** -0.5)
        ka = _l2norm(qkv[..., GDN_WIDTH:2 * GDN_WIDTH].reshape(b, s, GDN_HEADS, GDN_HEAD_DIM))
        va = qkv[..., 2 * GDN_WIDTH:].reshape(b, s, GDN_HEADS, GDN_HEAD_DIM)
        g_f = _gdn_decay(proj[..., C_AF:C_AB], a_log_f[l], dt_bias_f[l])
        g_b = _gdn_decay(proj[..., C_AB:C_BF], a_log_b[l], dt_bias_b[l])
        beta_f = jax.nn.sigmoid(proj[..., C_BF:C_BB])
        beta_b = jax.nn.sigmoid(proj[..., C_BB:C_QB])
        flip = lambda t: jnp.flip(t, axis=1)
        o_a = (_chunk_gated_delta(qa, ka, va, g_f, beta_f)
               + flip(_chunk_gated_delta(flip(qa), flip(ka), flip(va), flip(g_b), flip(beta_b))))
        z = proj[..., C_ZA:C_AF].reshape(b, s, GDN_HEADS, GDN_HEAD_DIM)
        o_a = _rmsnorm(o_a, norm_a[l]) * jax.nn.silu(z)
        o_a = o_a.reshape(b, s, GDN_WIDTH).astype(x.dtype)

        qb = proj[..., C_QB:C_KB].reshape(b, s, DIL_HEADS, DIL_HEAD_DIM)
        kb = proj[..., C_KB:C_VB].reshape(b, s, DIL_HEADS, DIL_HEAD_DIM)
        vb = proj[..., C_VB:C_GA].reshape(b, s, DIL_HEADS, DIL_HEAD_DIM)
        outs, lses = [], []
        for gi, (window, dil) in enumerate(DIL_GROUPS):
            hs = slice(gi * DIL_HEADS_PER_GROUP, (gi + 1) * DIL_HEADS_PER_GROUP)
            o_g, lse_g = _dilated_group(qb[:, :, hs], kb[:, :, hs], vb[:, :, hs], group_bias[gi],
                                        dil, window // (2 * dil))
            outs.append(o_g)
            lses.append(lse_g)
        wgt = jax.nn.softmax(jnp.stack(lses, axis=0), axis=0)
        o_b = jnp.sum(wgt[..., None] * jnp.stack(outs, axis=0), axis=0)
        o_b = o_b.reshape(b, s, DIL_OUT_WIDTH).astype(x.dtype)

        gate_a = jax.nn.sigmoid(proj[..., C_GA:C_GB]).astype(x.dtype)
        gate_b = jax.nn.sigmoid(proj[..., C_GB:IN_COLS]).astype(x.dtype)
        merged = (gate_a * jnp.einsum('bsc,cd->bsd', o_a, w_branch_a[l])
                  + gate_b * jnp.einsum('bsc,cd->bsd', o_b, w_branch_b[l]))
        y = jnp.einsum('bsd,de->bse', merged, w_out[l])
        x = x + _rmsnorm(y, ln_mix_post[l])

        h2 = _rmsnorm(x, ln_mlp_pre[l])
        f = jnp.square(jax.nn.relu(jnp.einsum('bsd,df->bsf', h2, w_ff1[l])))
        f = jnp.einsum('bsf,fd->bsd', f, w_ff2[l])
        x = x + _rmsnorm(f, ln_mlp_post[l])
    return x
```

```cpp
#include <hip/hip_runtime.h>
#include <cstdio>
#include <cstdint>

constexpr int D_MODEL = 1024, BATCH = 8, SEQ = 2048;
constexpr int GH = 8, GD = 128, GW = 1024;
constexpr int DH = 12, DHD = 128, DW = 1536, DOW = 512;
constexpr int D_FF = 4096;
constexpr float EPS = 1e-6f;
constexpr int C_QA = 0, C_KA = 1024, C_VA = 2048, C_ZA = 3072, C_AF = 4096, C_AB = 4104, C_BF = 4112, C_BB = 4120,
              C_QB = 4128, C_KB = C_QB + DW, C_VB = C_KB + DW, C_GA = C_VB + DW, C_GB = C_GA + 1024, IN_COLS = C_GB + 1024;
static_assert(IN_COLS == 10784, "cols");

__global__ void __launch_bounds__(256) k_gemm(const float* __restrict__ A, int lda, const float* __restrict__ B, int ldb,
                                              float* __restrict__ C, int ldc, int M, int N, int K) {
    __shared__ float As[16][65];
    __shared__ float Bs[16][65];
    const int tx = threadIdx.x & 15, ty = threadIdx.x >> 4;
    const int m0 = blockIdx.y * 64, n0 = blockIdx.x * 64;
    float acc[4][4];
#pragma unroll
    for (int i = 0; i < 4; ++i)
#pragma unroll
        for (int j = 0; j < 4; ++j) acc[i][j] = 0.f;
    for (int k0 = 0; k0 < K; k0 += 16) {
#pragma unroll
        for (int i = 0; i < 4; ++i) {
            const int e = threadIdx.x + i * 256;
            const int r = e >> 4, c = e & 15;
            const int gm = m0 + r;
            As[c][r] = (gm < M) ? A[(size_t)gm * lda + k0 + c] : 0.f;
        }
#pragma unroll
        for (int i = 0; i < 4; ++i) {
            const int e = threadIdx.x + i * 256;
            const int r = e >> 6, c = e & 63;
            const int gn = n0 + c;
            Bs[r][c] = (gn < N) ? B[(size_t)(k0 + r) * ldb + gn] : 0.f;
        }
        __syncthreads();
#pragma unroll
        for (int kk = 0; kk < 16; ++kk) {
            float a[4], b[4];
#pragma unroll
            for (int i = 0; i < 4; ++i) a[i] = As[kk][ty * 4 + i];
#pragma unroll
            for (int j = 0; j < 4; ++j) b[j] = Bs[kk][tx + 16 * j];
#pragma unroll
            for (int i = 0; i < 4; ++i)
#pragma unroll
                for (int j = 0; j < 4; ++j) acc[i][j] = fmaf(a[i], b[j], acc[i][j]);
        }
        __syncthreads();
    }
#pragma unroll
    for (int i = 0; i < 4; ++i) {
        const int gm = m0 + ty * 4 + i;
        if (gm >= M) continue;
#pragma unroll
        for (int j = 0; j < 4; ++j) {
            const int gn = n0 + tx + 16 * j;
            if (gn < N) C[(size_t)gm * ldc + gn] = acc[i][j];
        }
    }
}

__device__ __forceinline__ float wave_sum(float v) {
#pragma unroll
    for (int o = 1; o < 64; o <<= 1) v += __shfl_xor(v, o);
    return v;
}
__device__ __forceinline__ float wave_max(float v) {
#pragma unroll
    for (int o = 1; o < 64; o <<= 1) v = fmaxf(v, __shfl_xor(v, o));
    return v;
}
__device__ __forceinline__ float sigmoidf_(float x) { return 1.f / (1.f + expf(-x)); }
__device__ __forceinline__ float siluf_(float x) { return x / (1.f + expf(-x)); }
__device__ __forceinline__ float softplusf_(float x) { return x > 20.f ? x : log1pf(expf(x)); }

__global__ void __launch_bounds__(256) k_rmsnorm(const float* __restrict__ in, const float* __restrict__ w, const float* __restrict__ res,
                                                  float* __restrict__ out, int rows) {
    const int row = blockIdx.x * 4 + (threadIdx.x >> 6), lane = threadIdx.x & 63;
    if (row >= rows) return;
    const float* p = in + (size_t)row * 1024;
    float v[16]; float s = 0.f;
#pragma unroll
    for (int j = 0; j < 16; ++j) { v[j] = p[lane + 64 * j]; s += v[j] * v[j]; }
    s = wave_sum(s);
    const float r = rsqrtf(s * (1.f / 1024.f) + EPS);
#pragma unroll
    for (int j = 0; j < 16; ++j) {
        const int c = lane + 64 * j;
        float o = v[j] * r * w[c];
        if (res) o += res[(size_t)row * 1024 + c];
        out[(size_t)row * 1024 + c] = o;
    }
}

__global__ void __launch_bounds__(128) k_conv(const float* __restrict__ proj, const float* __restrict__ conv_w,
                                              const float* __restrict__ a_log_f, const float* __restrict__ a_log_b,
                                              const float* __restrict__ dt_f, const float* __restrict__ dt_b,
                                              float* __restrict__ qkvn, float* __restrict__ gb) {
    const int s = blockIdx.x, part = blockIdx.y;
    const int d = threadIdx.x;
    const int c = part * 128 + d;
    float acc = 0.f;
#pragma unroll
    for (int t = 0; t < 5; ++t) {
        const int ss = s + t - 2;
        if (ss >= 0 && ss < SEQ) acc += proj[(size_t)ss * IN_COLS + C_QA + c] * conv_w[t * 3072 + c];
    }
    float y = siluf_(acc);
    if (part < 16) {
        __shared__ float red[2];
        float ss = wave_sum(y * y);
        if ((threadIdx.x & 63) == 0) red[threadIdx.x >> 6] = ss;
        __syncthreads();
        const float tot = red[0] + red[1];
        y = y * rsqrtf(tot + EPS);
        if (part < 8) y *= 0.08838834764831845f;
    }
    qkvn[(size_t)s * 3072 + c] = y;
    if (part == 0 && d < 32) {
        const float a = proj[(size_t)s * IN_COLS + C_AF + d];
        float o;
        if (d < 8) o = -expf(a_log_f[d]) * softplusf_(a + dt_f[d]);
        else if (d < 16) o = -expf(a_log_b[d - 8]) * softplusf_(a + dt_b[d - 8]);
        else o = sigmoidf_(a);
        gb[s * 32 + d] = o;
    }
}

__global__ void __launch_bounds__(128) k_gdn(const float* __restrict__ qkvn, const float* __restrict__ gb, float* __restrict__ o_f, float* __restrict__ o_b) {
    const int h = blockIdx.x, dir = blockIdx.y, j = threadIdx.x;
    __shared__ float sk[128], sq[128];
    float S[128];
#pragma unroll
    for (int i = 0; i < 128; ++i) S[i] = 0.f;
    float* outp = dir ? o_b : o_f;
    for (int step = 0; step < SEQ; ++step) {
        const int t = dir ? (SEQ - 1 - step) : step;
        const float* row = qkvn + (size_t)t * 3072;
        sq[j] = row[h * 128 + j];
        sk[j] = row[1024 + h * 128 + j];
        const float v = row[2048 + h * 128 + j];
        const float g = gb[t * 32 + dir * 8 + h], b = gb[t * 32 + 16 + dir * 8 + h];
        __syncthreads();
        const float eg = expf(g);
        float kS = 0.f;
#pragma unroll
        for (int i = 0; i < 128; ++i) kS = fmaf(sk[i], S[i], kS);
        const float c = b * (v - eg * kS);
        float o = 0.f;
#pragma unroll
        for (int i = 0; i < 128; ++i) { S[i] = fmaf(sk[i], c, eg * S[i]); o = fmaf(sq[i], S[i], o); }
        outp[(size_t)t * 1024 + h * 128 + j] = o;
        __syncthreads();
    }
}

__global__ void __launch_bounds__(256) k_gate_a(const float* __restrict__ o_f, const float* __restrict__ o_b, const float* __restrict__ proj,
                                                 const float* __restrict__ norm_a, float* __restrict__ oa) {
    const int idx = blockIdx.x * 4 + (threadIdx.x >> 6), lane = threadIdx.x & 63;
    const int s = idx >> 3, h = idx & 7;
    const size_t base = (size_t)s * 1024 + h * 128;
    const float v0 = o_f[base + lane] + o_b[base + lane], v1 = o_f[base + lane + 64] + o_b[base + lane + 64];
    const float ss = wave_sum(v0 * v0 + v1 * v1);
    const float r = rsqrtf(ss * (1.f / 128.f) + EPS);
    const float z0 = proj[(size_t)s * IN_COLS + C_ZA + h * 128 + lane], z1 = proj[(size_t)s * IN_COLS + C_ZA + h * 128 + lane + 64];
    oa[base + lane] = v0 * r * norm_a[lane] * siluf_(z0);
    oa[base + lane + 64] = v1 * r * norm_a[lane + 64] * siluf_(z1);
}

__device__ __forceinline__ int t5_bucket(int rel) {
    const int n = rel < 0 ? -rel : rel;
    int b;
    if (n < 8) b = n; else if (n < 15) b = 8; else if (n < 27) b = 9; else if (n < 50) b = 10; else if (n < 91) b = 11;
    else if (n < 166) b = 12; else if (n < 305) b = 13; else if (n < 559) b = 14; else b = 15;
    return b + (rel > 0 ? 16 : 0);
}

__global__ void __launch_bounds__(64) k_attn(const float* __restrict__ proj, const float* __restrict__ rel_bias, float* __restrict__ oh, float* __restrict__ lse_out) {
    const int pos = blockIdx.x, head = blockIdx.y, lane = threadIdx.x;
    const int g = head >> 2;
    const int dil = g == 0 ? 1 : (g == 1 ? 4 : 16);
    __shared__ float sq[128];
    __shared__ float sp[192];
    const float* qrow = proj + (size_t)pos * IN_COLS + C_QB + head * 128;
    sq[lane] = qrow[lane]; sq[lane + 64] = qrow[lane + 64];
    __syncthreads();
    float lg[3];
    float mx = -1e30f;
#pragma unroll
    for (int r = 0; r < 3; ++r) {
        const int m = lane + 64 * r - 64;
        const int kp = pos + m * dil;
        float l = -1e30f;
        if (m <= 64 && kp >= 0 && kp < SEQ) {
            const float* krow = proj + (size_t)kp * IN_COLS + C_KB + head * 128;
            float dot = 0.f;
            for (int d = 0; d < 128; ++d) dot = fmaf(sq[d], krow[d], dot);
            l = dot * 0.08838834764831845f + rel_bias[t5_bucket(m * dil) * DH + head];
        }
        lg[r] = l;
        mx = fmaxf(mx, l);
    }
    mx = wave_max(mx);
    float se = 0.f;
#pragma unroll
    for (int r = 0; r < 3; ++r) { const float e = (lg[r] > -1e29f) ? expf(lg[r] - mx) : 0.f; lg[r] = e; se += e; }
    se = wave_sum(se);
    const float inv = 1.f / se;
#pragma unroll
    for (int r = 0; r < 3; ++r) sp[lane + 64 * r] = lg[r] * inv;
    __syncthreads();
    float o0 = 0.f, o1 = 0.f;
    for (int i = 0; i < 129; ++i) {
        const int m = i - 64;
        const int kp = pos + m * dil;
        if (kp < 0 || kp >= SEQ) continue;
        const float p = sp[i];
        const float* vrow = proj + (size_t)kp * IN_COLS + C_VB + head * 128;
        o0 = fmaf(p, vrow[lane], o0); o1 = fmaf(p, vrow[lane + 64], o1);
    }
    oh[((size_t)pos * DH + head) * 128 + lane] = o0;
    oh[((size_t)pos * DH + head) * 128 + lane + 64] = o1;
    if (lane == 0) lse_out[pos * DH + head] = mx + logf(se);
}

__global__ void __launch_bounds__(512) k_comb(const float* __restrict__ oh, const float* __restrict__ lse, float* __restrict__ ob) {
    const int s = blockIdx.x, c = threadIdx.x, j = c >> 7, d = c & 127;
    const float l0 = lse[s * DH + j], l1 = lse[s * DH + 4 + j], l2 = lse[s * DH + 8 + j];
    const float m = fmaxf(l0, fmaxf(l1, l2));
    const float e0 = expf(l0 - m), e1 = expf(l1 - m), e2 = expf(l2 - m);
    const float inv = 1.f / (e0 + e1 + e2);
    ob[(size_t)s * 512 + c] = (e0 * oh[((size_t)s * DH + j) * 128 + d] + e1 * oh[((size_t)s * DH + 4 + j) * 128 + d] + e2 * oh[((size_t)s * DH + 8 + j) * 128 + d]) * inv;
}

__global__ void __launch_bounds__(256) k_merge(const float* __restrict__ proj, const float* __restrict__ ya, const float* __restrict__ yb, float* __restrict__ mg) {
    const int i = blockIdx.x * 256 + threadIdx.x;
    const int s = i >> 10, c = i & 1023;
    const float ga = sigmoidf_(proj[(size_t)s * IN_COLS + C_GA + c]), gbv = sigmoidf_(proj[(size_t)s * IN_COLS + C_GB + c]);
    mg[i] = ga * ya[i] + gbv * yb[i];
}

__global__ void __launch_bounds__(256) k_relu2(float* __restrict__ f, size_t n) {
    const size_t i = (size_t)blockIdx.x * 256 + threadIdx.x;
    if (i < n) { const float v = fmaxf(f[i], 0.f); f[i] = v * v; }
}

static void gemm(const float* A, int lda, const float* B, int ldb, float* C, int ldc, int M, int N, int K, hipStream_t st) {
    dim3 grid((N + 63) / 64, (M + 63) / 64);
    hipLaunchKernelGGL(k_gemm, grid, dim3(256), 0, st, A, lda, B, ldb, C, ldc, M, N, K);
}

extern "C" void kernel_launch(void* const* d_in, const int* in_sizes, int n_in, void* d_out, int out_size, void* d_ws, size_t ws_size, hipStream_t stream) {
    const float* x = (const float*)d_in[0];
    const float* rel_bias = (const float*)d_in[1];
    const float* ln_mix_pre = (const float*)d_in[2];
    const float* w_in = (const float*)d_in[3];
    const float* conv_w = (const float*)d_in[4];
    const float* a_log_f = (const float*)d_in[5];
    const float* a_log_b = (const float*)d_in[6];
    const float* dt_bias_f = (const float*)d_in[7];
    const float* dt_bias_b = (const float*)d_in[8];
    const float* norm_a = (const float*)d_in[9];
    const float* w_branch_a = (const float*)d_in[10];
    const float* w_branch_b = (const float*)d_in[11];
    const float* w_out = (const float*)d_in[12];
    const float* ln_mix_post = (const float*)d_in[13];
    const float* ln_mlp_pre = (const float*)d_in[14];
    const float* w_ff1 = (const float*)d_in[15];
    const float* w_ff2 = (const float*)d_in[16];
    const float* ln_mlp_post = (const float*)d_in[17];
    float* out = (float*)d_out;
    float* ws = (float*)d_ws;
    const int S = SEQ;
    size_t off = 0;
    auto take = [&](size_t n) { float* p = ws + off; off += (n + 63) & ~(size_t)63; return p; };
    float* XN = take((size_t)S * 1024);
    float* PROJ = take((size_t)S * IN_COLS);
    float* QKVN = take((size_t)S * 3072);
    float* GB = take((size_t)S * 32);
    float* OF = take((size_t)S * 1024);
    float* OB_ = take((size_t)S * 1024);
    float* OA = take((size_t)S * 1024);
    float* OH = take((size_t)S * DH * 128);
    float* LSE = take((size_t)S * DH);
    float* OBC = take((size_t)S * 512);
    float* YA = take((size_t)S * 1024);
    float* YB = take((size_t)S * 1024);
    float* MG = take((size_t)S * 1024);
    float* Y = take((size_t)S * 1024);
    float* X1 = take((size_t)S * 1024);
    float* H2 = take((size_t)S * 1024);
    float* F = take((size_t)S * D_FF);
    float* F2 = take((size_t)S * 1024);
    if (off * 4 > ws_size) { fprintf(stderr, "workspace too small: need %zu have %zu\n", off * 4, ws_size); return; }
    for (int b = 0; b < BATCH; ++b) {
        const float* xb = x + (size_t)b * S * 1024;
        float* outb = out + (size_t)b * S * 1024;
        hipLaunchKernelGGL(k_rmsnorm, dim3(S / 4), dim3(256), 0, stream, xb, ln_mix_pre, (const float*)nullptr, XN, S);
        gemm(XN, 1024, w_in, IN_COLS, PROJ, IN_COLS, S, IN_COLS, 1024, stream);
        hipLaunchKernelGGL(k_conv, dim3(S, 24), dim3(128), 0, stream, PROJ, conv_w, a_log_f, a_log_b, dt_bias_f, dt_bias_b, QKVN, GB);
        hipLaunchKernelGGL(k_gdn, dim3(8, 2), dim3(128), 0, stream, QKVN, GB, OF, OB_);
        hipLaunchKernelGGL(k_gate_a, dim3(S * 8 / 4), dim3(256), 0, stream, OF, OB_, PROJ, norm_a, OA);
        hipLaunchKernelGGL(k_attn, dim3(S, DH), dim3(64), 0, stream, PROJ, rel_bias, OH, LSE);
        hipLaunchKernelGGL(k_comb, dim3(S), dim3(512), 0, stream, OH, LSE, OBC);
        gemm(OA, 1024, w_branch_a, 1024, YA, 1024, S, 1024, 1024, stream);
        gemm(OBC, 512, w_branch_b, 1024, YB, 1024, S, 1024, 512, stream);
        hipLaunchKernelGGL(k_merge, dim3(S * 1024 / 256), dim3(256), 0, stream, PROJ, YA, YB, MG);
        gemm(MG, 1024, w_out, 1024, Y, 1024, S, 1024, 1024, stream);
        hipLaunchKernelGGL(k_rmsnorm, dim3(S / 4), dim3(256), 0, stream, Y, ln_mix_post, xb, X1, S);
        hipLaunchKernelGGL(k_rmsnorm, dim3(S / 4), dim3(256), 0, stream, X1, ln_mlp_pre, (const float*)nullptr, H2, S);
        gemm(H2, 1024, w_ff1, D_FF, F, D_FF, S, D_FF, 1024, stream);
        hipLaunchKernelGGL(k_relu2, dim3((unsigned)(((size_t)S * D_FF + 255) / 256)), dim3(256), 0, stream, F, (size_t)S * D_FF);
        gemm(F, D_FF, w_ff2, 1024, F2, 1024, S, 1024, D_FF, stream);
        hipLaunchKernelGGL(k_rmsnorm, dim3(S / 4), dim3(256), 0, stream, F2, ln_mlp_post, X1, outb, S);
    }
}
```
